# Optimizing an MI355X kernel written in HIP

```python
import jax, jax.numpy as jnp
from jax import lax
import numpy as np

D_MODEL = 1024
BATCH = 4
SEQ = 4096
DEPTH = 2

CHUNK = 64
SGU_GROUPS = 4
SGU_GROUP_DIM = 64
SGU_WIDTH = SGU_GROUPS * SGU_GROUP_DIM
SGU_BLOCK = 128
RET_HEADS = 4
RET_KDIM = 64
RET_VDIM = 64
POOL_WINDOWS = (2, 4, 8, 16)
POOL_GROUP_DIM = 64
POOL_WIDTH = 4 * POOL_GROUP_DIM
MLA_HEADS = 4
MLA_Q_RANK = 256
MLA_KV_RANK = 128
MLA_NOPE_DIM = 64
MLA_ROPE_DIM = 32
MLA_V_DIM = 64
Q_BLOCK = 128
ROPE_BASE = 10000.0
N_BRANCH = 4
BRANCH_WIDTH = 256
D_FF = 2816
PLE_DIM = 256
ALPHA = (2 * DEPTH) ** 0.25
BETA = (8 * DEPTH) ** -0.25
LN_EPS = 1e-5
RMS_EPS = 1e-6
GN_EPS = 1e-5
IN_SIZES = (SGU_WIDTH, SGU_WIDTH,
            RET_HEADS * RET_KDIM, RET_HEADS * RET_KDIM, RET_HEADS * RET_VDIM, RET_HEADS * RET_VDIM,
            POOL_WIDTH,
            MLA_Q_RANK, MLA_KV_RANK, MLA_ROPE_DIM,
            N_BRANCH * D_MODEL)
IN_COLS = sum(IN_SIZES)

kernel_name = 'hybrid_gated_streaming_block'


def _split(h, sizes):
    parts, start = [], 0
    for size in sizes:
        parts.append(h[..., start:start + size])
        start += size
    return parts


def layer_norm(x, g, b):
    xf = x.astype(jnp.float32)
    mu = jnp.mean(xf, axis=-1, keepdims=True)
    var = jnp.mean(jnp.square(xf - mu), axis=-1, keepdims=True)
    y = (xf - mu) * lax.rsqrt(var + LN_EPS) * g.astype(jnp.float32) + b.astype(jnp.float32)
    return y.astype(x.dtype)


def rms_norm(x, g):
    xf = x.astype(jnp.float32)
    y = xf * lax.rsqrt(jnp.mean(jnp.square(xf), axis=-1, keepdims=True) + RMS_EPS) * g.astype(jnp.float32)
    return y.astype(x.dtype)


def rope_tables(positions, dim):
    inv_freq = ROPE_BASE ** (-jnp.arange(0, dim, 2, dtype=jnp.float32) / dim)
    ang = positions.astype(jnp.float32)[..., None] * inv_freq
    return jnp.cos(ang), jnp.sin(ang)


def apply_rope(x, cos, sin):
    half = x.shape[-1] // 2
    xf = x.astype(jnp.float32)
    x1, x2 = xf[..., :half], xf[..., half:]
    c, s = cos[:, :, None, :], sin[:, :, None, :]
    return jnp.concatenate([x1 * c - x2 * s, x1 * s + x2 * c], axis=-1).astype(x.dtype)


def swiglu(x, w_up, w_down):
    a, b = jnp.split(x @ w_up, 2, axis=-1)
    return (jax.nn.silu(a) * b) @ w_down


def sgu_mixer(u, v, ln_g, ln_b, w_s, b_s):
    bsz, seq, _ = u.shape
    u = jax.nn.gelu(u)
    v = layer_norm(jax.nn.gelu(v), ln_g, ln_b)
    vb = v.reshape(bsz, seq // SGU_BLOCK, SGU_BLOCK, SGU_GROUPS, SGU_GROUP_DIM)
    causal = jnp.tril(jnp.ones((SGU_BLOCK, SGU_BLOCK), dtype=bool))
    w = jnp.where(causal[None], w_s, jnp.zeros_like(w_s))
    mixed = jnp.einsum('gts,bnsgc->bntgc', w, vb) + b_s.T[None, None, :, :, None]
    return u * mixed.reshape(bsz, seq, SGU_WIDTH)


def retention_mixer(q, k, v, g, cos, sin):
    bsz, seq, _ = q.shape
    n_chunks = seq // CHUNK
    f32 = jnp.float32
    q = apply_rope(q.reshape(bsz, seq, RET_HEADS, RET_KDIM), cos, sin).astype(f32)
    k = apply_rope(k.reshape(bsz, seq, RET_HEADS, RET_KDIM), cos, sin).astype(f32) * RET_KDIM ** -0.5
    v = v.reshape(bsz, seq, RET_HEADS, RET_VDIM).astype(f32)
    log_gamma = jnp.log1p(-jnp.exp2(-5.0 - jnp.arange(RET_HEADS, dtype=f32)))
    pos = jnp.arange(CHUNK, dtype=f32)
    intra_decay = jnp.exp(log_gamma[:, None, None] * jnp.abs(pos[:, None] - pos[None, :]))
    key_to_end = jnp.exp(log_gamma[:, None] * (CHUNK - 1 - pos)[None, :])
    start_to_query = jnp.exp(log_gamma[:, None] * (pos + 1)[None, :])
    chunk_decay = jnp.exp(log_gamma * CHUNK)
    qc = q.reshape(bsz, n_chunks, CHUNK, RET_HEADS, RET_KDIM)
    kc = k.reshape(bsz, n_chunks, CHUNK, RET_HEADS, RET_KDIM)
    vc = v.reshape(bsz, n_chunks, CHUNK, RET_HEADS, RET_VDIM)
    scores = jnp.einsum('bnihd,bnjhd->bnhij', qc, kc) * intra_decay
    y = jnp.einsum('bnhij,bnjhe->bnihe', scores, vc)
    kv = jnp.einsum('bnjhd,hj,bnjhe->nbhde', kc, key_to_end, vc)

    def step(state, kv_chunk):
        return state * chunk_decay[None, :, None, None] + kv_chunk, state

    _, prev = lax.scan(step, jnp.zeros((bsz, RET_HEADS, RET_KDIM, RET_VDIM), f32), kv)
    y = y + jnp.einsum('bnihd,nbhde,hi->bnihe', qc, prev, start_to_query)
    y = y.reshape(bsz, seq, RET_HEADS, RET_VDIM)
    mu = jnp.mean(y, axis=-1, keepdims=True)
    var = jnp.mean(jnp.square(y - mu), axis=-1, keepdims=True)
    y = (y - mu) * lax.rsqrt(var + GN_EPS)
    return (jax.nn.silu(g.astype(f32)) * y.reshape(bsz, seq, RET_HEADS * RET_VDIM)).astype(g.dtype)


def pool_mixer(z, w_pool, scale):
    bsz, seq, _ = z.shape
    zf = z.astype(jnp.float32)
    csum = jnp.concatenate([jnp.zeros((bsz, 1, POOL_WIDTH), jnp.float32), jnp.cumsum(zf, axis=1)], axis=1)
    t = jnp.arange(seq)
    groups = []
    for gi, window in enumerate(POOL_WINDOWS):
        ch = slice(gi * POOL_GROUP_DIM, (gi + 1) * POOL_GROUP_DIM)
        lo = jnp.maximum(t + 1 - window, 0)
        count = (t + 1 - lo).astype(jnp.float32)[None, :, None]
        mean = (csum[:, 1:, ch] - csum[:, lo, ch]) / count
        groups.append(mean - zf[:, :, ch])
    pooled = jnp.stack(groups, axis=2).astype(z.dtype)
    y = jnp.einsum('bsgc,gcd->bsgd', pooled, w_pool).reshape(bsz, seq, POOL_WIDTH)
    return y * scale


def mla_mixer(c_q, c_kv, k_rope, q_norm_g, kv_norm_g, w_uq, w_ukv, cos, sin):
    bsz, seq, _ = c_q.shape
    qk_dim = MLA_NOPE_DIM + MLA_ROPE_DIM
    q = (rms_norm(c_q, q_norm_g) @ w_uq).reshape(bsz, seq, MLA_HEADS, qk_dim)
    kv = (rms_norm(c_kv, kv_norm_g) @ w_ukv).reshape(bsz, seq, MLA_HEADS, MLA_NOPE_DIM + MLA_V_DIM)
    k_nope, v = kv[..., :MLA_NOPE_DIM], kv[..., MLA_NOPE_DIM:]
    q = jnp.concatenate([q[..., :MLA_NOPE_DIM], apply_rope(q[..., MLA_NOPE_DIM:], cos, sin)], axis=-1) * qk_dim ** -0.5
    k_pe = apply_rope(k_rope[:, :, None, :], cos, sin)
    k = jnp.concatenate([k_nope, jnp.broadcast_to(k_pe, (bsz, seq, MLA_HEADS, MLA_ROPE_DIM))], axis=-1)
    n_blocks = seq // Q_BLOCK
    q_blocks = jnp.moveaxis(q.reshape(bsz, n_blocks, Q_BLOCK, MLA_HEADS, qk_dim), 1, 0)
    key_chunk = jnp.arange(seq) // CHUNK

    def attend(args):
        q_blk, blk = args
        query_chunk = (blk * Q_BLOCK + jnp.arange(Q_BLOCK)) // CHUNK
        s = jnp.einsum('bqhd,bkhd->bhqk', q_blk, k).astype(jnp.float32)
        s = jnp.where(key_chunk[None, :] <= query_chunk[:, None], s, -jnp.inf)
        probs = jax.nn.softmax(s, axis=-1).astype(v.dtype)
        return jnp.einsum('bhqk,bkhe->bqhe', probs, v)

    out = lax.map(attend, (q_blocks, jnp.arange(n_blocks)))
    return jnp.moveaxis(out, 0, 1).reshape(bsz, seq, MLA_HEADS * MLA_V_DIM)


def token_mix(x, w_in, sgu_ln_g, sgu_ln_b, sgu_w, sgu_b, pool_w, pool_scale,
              mla_q_norm, mla_kv_norm, mla_w_uq, mla_w_ukv, w_branch, w_out,
              ret_cos, ret_sin, mla_cos, mla_sin):
    bsz, seq, dm = x.shape
    (sgu_u, sgu_v, ret_q, ret_k, ret_v, ret_g, pool_in,
     c_q, c_kv, k_rope, gate_logits) = _split(x @ w_in, IN_SIZES)
    ys = (sgu_mixer(sgu_u, sgu_v, sgu_ln_g, sgu_ln_b, sgu_w, sgu_b).astype(x.dtype),
          retention_mixer(ret_q, ret_k, ret_v, ret_g, ret_cos, ret_sin).astype(x.dtype),
          pool_mixer(pool_in, pool_w, pool_scale).astype(x.dtype),
          mla_mixer(c_q, c_kv, k_rope, mla_q_norm, mla_kv_norm, mla_w_uq, mla_w_ukv, mla_cos, mla_sin).astype(x.dtype))
    gates = jax.nn.sigmoid(gate_logits).reshape(bsz, seq, N_BRANCH, dm)
    merged = gates[:, :, 0] * (ys[0] @ w_branch[0])
    for n in range(1, N_BRANCH):
        merged = merged + gates[:, :, n] * (ys[n] @ w_branch[n])
    return merged @ w_out


def setup_inputs(seed: int = 0) -> dict:
    key = jax.random.key(seed)
    ks = jax.random.split(key, 32)

    def nrm(k, shape, scale):
        return jax.random.normal(k, shape, jnp.float32) * scale

    def gain(k, shape):
        return 1.0 + 0.05 * jax.random.normal(k, shape, jnp.float32)

    def bias(k, shape):
        return 0.02 * jax.random.normal(k, shape, jnp.float32)

    offset = jax.random.randint(ks[2], (BATCH, 1), 0, 64, dtype=jnp.int32) * CHUNK
    positions = (offset + jnp.arange(SEQ, dtype=jnp.int32)[None, :]).astype(jnp.int32)
    L, D = DEPTH, D_MODEL
    return {
        'x': nrm(ks[0], (BATCH, SEQ, D), 1.0),
        'p': nrm(ks[1], (DEPTH, BATCH, SEQ, PLE_DIM), 1.0),
        'positions': positions,
        'ffn1_up': nrm(ks[3], (L, D, 2 * D_FF), D ** -0.5),
        'ffn1_down': nrm(ks[4], (L, D_FF, D), BETA * D_FF ** -0.5),
        'ln1_g': gain(ks[5], (L, D)),
        'ln1_b': bias(ks[6], (L, D)),
        'w_in': nrm(ks[7], (L, D, IN_COLS), D ** -0.5),
        'sgu_ln_g': gain(ks[8], (L, SGU_WIDTH)),
        'sgu_ln_b': bias(ks[9], (L, SGU_WIDTH)),
        'sgu_w': nrm(ks[10], (L, SGU_GROUPS, SGU_BLOCK, SGU_BLOCK), SGU_BLOCK ** -0.5),
        'sgu_b': 1.0 + 0.1 * jax.random.normal(ks[11], (L, SGU_GROUPS, SGU_BLOCK), jnp.float32),
        'pool_w': nrm(ks[12], (L, 4, POOL_GROUP_DIM, POOL_GROUP_DIM), POOL_GROUP_DIM ** -0.5),
        'pool_scale': gain(ks[13], (L, POOL_WIDTH)),
        'mla_q_norm': gain(ks[14], (L, MLA_Q_RANK)),
        'mla_kv_norm': gain(ks[15], (L, MLA_KV_RANK)),
        'mla_w_uq': nrm(ks[16], (L, MLA_Q_RANK, MLA_HEADS * (MLA_NOPE_DIM + MLA_ROPE_DIM)), MLA_Q_RANK ** -0.5),
        'mla_w_ukv': nrm(ks[17], (L, MLA_KV_RANK, MLA_HEADS * (MLA_NOPE_DIM + MLA_V_DIM)), MLA_KV_RANK ** -0.5),
        'w_branch': nrm(ks[18], (L, N_BRANCH, BRANCH_WIDTH, D), BRANCH_WIDTH ** -0.5),
        'w_out': nrm(ks[19], (L, D, D), BETA * D ** -0.5),
        'ln2_g': gain(ks[20], (L, D)),
        'ln2_b': bias(ks[21], (L, D)),
        'ffn2_up': nrm(ks[22], (L, D, 2 * D_FF), D ** -0.5),
        'ffn2_down': nrm(ks[23], (L, D_FF, D), BETA * D_FF ** -0.5),
        'w_ple_gate': nrm(ks[24], (L, D, D), D ** -0.5),
        'w_ple': nrm(ks[25], (L, PLE_DIM, D), PLE_DIM ** -0.5),
        'ln3_g': gain(ks[26], (L, D)),
        'ln3_b': bias(ks[27], (L, D)),
    }


def reference(x, p, positions, ffn1_up, ffn1_down, ln1_g, ln1_b, w_in, sgu_ln_g, sgu_ln_b,
              sgu_w, sgu_b, pool_w, pool_scale, mla_q_norm, mla_kv_norm, mla_w_uq, mla_w_ukv,
              w_branch, w_out, ln2_g, ln2_b, ffn2_up, ffn2_down, w_ple_gate, w_ple, ln3_g, ln3_b):
    ret_cos, ret_sin = rope_tables(positions, RET_KDIM)
    mla_cos, mla_sin = rope_tables(positions, MLA_ROPE_DIM)
    for i in range(DEPTH):
        x = layer_norm(ALPHA * x + 0.5 * swiglu(x, ffn1_up[i], ffn1_down[i]), ln1_g[i], ln1_b[i])
        mix = token_mix(x, w_in[i], sgu_ln_g[i], sgu_ln_b[i], sgu_w[i], sgu_b[i], pool_w[i], pool_scale[i],
                        mla_q_norm[i], mla_kv_norm[i], mla_w_uq[i], mla_w_ukv[i], w_branch[i], w_out[i],
                        ret_cos, ret_sin, mla_cos, mla_sin)
        x = layer_norm(ALPHA * x + mix, ln2_g[i], ln2_b[i])
        ple = jax.nn.sigmoid(x @ w_ple_gate[i]) * (p[i] @ w_ple[i])
        x = layer_norm(ALPHA * x + 0.5 * swiglu(x, ffn2_up[i], ffn2_down[i]) + ple, ln3_g[i], ln3_b[i])
    return x
```

```cpp
#include <hip/hip_runtime.h>
#include <cstdio>
#include <cstdint>
#include <cmath>

#ifndef PER_PHASE_LAUNCH
#define PER_PHASE_LAUNCH 1
#endif

#define LAS __attribute__((address_space(3)))
#define GAS __attribute__((address_space(1)))
typedef unsigned short bf16;
typedef float f32x4 __attribute__((ext_vector_type(4)));
typedef unsigned u32x4 __attribute__((ext_vector_type(4)));
typedef unsigned u32x2 __attribute__((ext_vector_type(2)));

constexpr int NB = 4, SEQ = 4096, T = NB * SEQ, DM = 1024, FF = 2816, DEPTH = 2;
constexpr int NIN = 6304, NINP = 6400;
constexpr float ALPHA = 1.41421356237309515f;
constexpr float LN_EPS = 1e-5f, RMS_EPS = 1e-6f, GN_EPS = 1e-5f;
constexpr float QSCALE = 0.10206207261596577f * 1.4426950408889634f;

constexpr size_t MiB = 1u << 20;
constexpr size_t OFF_CTL = 0, CTL_BYTES = 1 * MiB;
constexpr size_t OFF_XCH = 1 * MiB;
constexpr size_t OFF_RCOS = 2 * MiB, OFF_RSIN = 4 * MiB, OFF_MCOS = 6 * MiB, OFF_MSIN = 7 * MiB;
constexpr size_t OFF_W = 8 * MiB;
constexpr size_t W_UP = OFF_W, W_DOWN = W_UP + (size_t)2 * FF * DM * 2, W_PG = W_DOWN + (size_t)DM * FF * 2, W_PLE = W_PG + (size_t)DM * DM * 2;
constexpr size_t W_IN = OFF_W + 19 * MiB;
constexpr size_t W_UQ = W_IN + (size_t)NINP * DM * 2;
constexpr size_t W_UKV = W_UQ + 512 * 256 * 2;
constexpr size_t W_BR = W_UKV + 512 * 256 * 2;
constexpr size_t W_OUT = W_BR + (size_t)4 * DM * 256 * 2;
constexpr size_t W_SGU = W_OUT + (size_t)DM * DM * 2;
constexpr size_t W_POOL = W_SGU + 4 * 128 * 128 * 2;
constexpr size_t OFF_C = 45 * MiB;
constexpr size_t OFF_D = 77 * MiB;
constexpr size_t OFF_E = 157 * MiB;
constexpr size_t OFF_F = 285 * MiB;
constexpr size_t WS_END = 293 * MiB;
static_assert(W_POOL + 4 * 64 * 64 * 2 <= OFF_C, "weights fit");
constexpr size_t TEN = (size_t)T * 256 * 2;
constexpr size_t D_X2B = OFF_D, D_PB = OFF_D + 4 * TEN, D_XB0 = OFF_D + 5 * TEN;
constexpr size_t C_QM = OFF_C, C_KN = OFF_C + (size_t)T * 384 * 2, C_VT = C_KN + TEN;
static_assert(C_VT + TEN <= OFF_D, "C map");

constexpr int CW_TMO = 0, CW_CODE = 1, CW_BAR = 4096, CW_SEAM = 16384, SEAM_BANK = 64 * 64;

constexpr int NWAVES = 8, NTHREADS = 512, LDS_BYTES = 147456;

__device__ __forceinline__ unsigned f2bf(float f) { unsigned u = __builtin_bit_cast(unsigned, f); return (u + 0x7fffu + ((u >> 16) & 1u)) >> 16; }
__device__ __forceinline__ float bf2f(unsigned h) { return __builtin_bit_cast(float, h << 16); }
__device__ __forceinline__ float bfround(float f) { return bf2f(f2bf(f)); }
__device__ __forceinline__ unsigned pk2(float lo, float hi) { return f2bf(lo) | (f2bf(hi) << 16); }
__device__ __forceinline__ float sigmoidf_(float x) { return 1.0f / (1.0f + __expf(-x)); }
__device__ __forceinline__ float siluf_(float x) { return x / (1.0f + __expf(-x)); }
__device__ __forceinline__ float gelu_tanh(float x) { const float u = 0.7978845608028654f * (x + 0.044715f * x * x * x); const float e = __expf(-2.0f * u); return x / (1.0f + e); }
__device__ __forceinline__ float wave_sum(float v) {
#pragma unroll
    for (int o = 1; o < 64; o <<= 1) v += __shfl_xor(v, o);
    return v;
}

struct Args {
    const float* in[28]; const int* pos; float* out; unsigned char* ws;
    int ph_lo, ph_hi;
};
__constant__ float c_invf[48] = {1.0f, 0.7498942017555237f, 0.5623413324356079f, 0.4216965138912201f, 0.3162277638912201f, 0.23713737726211548f, 0.17782793939113617f, 0.1333521455526352f, 0.10000000149011612f, 0.0749894231557846f, 0.05623413249850273f, 0.04216964915394783f, 0.03162277489900589f, 0.023713737726211548f, 0.017782794311642647f, 0.013335213996469975f, 0.009999999776482582f, 0.007498942315578461f, 0.005623413249850273f, 0.0042169648222625256f, 0.003162277629598975f, 0.0023713738191872835f, 0.0017782794311642647f, 0.0013335214462131262f, 0.0010000000474974513f, 0.0007498941849917173f, 0.000562341301701963f, 0.0004216965171508491f, 0.0003162277571391314f, 0.00023713737027719617f, 0.00017782794020604342f, 0.0001333521504420787f,
    1.0f, 0.5623413324356079f, 0.3162277638912201f, 0.17782793939113617f, 0.10000000149011612f, 0.05623413249850273f, 0.03162277489900589f, 0.017782794311642647f, 0.009999999776482582f, 0.005623413249850273f, 0.003162277629598975f, 0.0017782794311642647f, 0.0010000000474974513f, 0.000562341301701963f, 0.0003162277571391314f, 0.00017782794020604342f};
__device__ __forceinline__ float lg2g(int h) { return h == 0 ? -0.04580368846654892f : h == 1 ? -0.022720076143741608f : h == 2 ? -0.011315313167870045f : -0.00564656313508749f; }

struct Ctx {
    Args a; unsigned char* ws; float* out; char* lds; int tid, lane, wave, wg, G;
    __device__ __forceinline__ const float* in(int i) const { return a.in[i]; }
    __device__ __forceinline__ bf16* D(int t) const { return (bf16*)(ws + OFF_D + (size_t)t * TEN); }
};

template <class Map> __device__ void conv_mat(const Ctx& c, const float* W, int ldw, int ksrc, int Kout, int Nout, bf16* out, Map map, int& item, const int nitem_stride) {
    float* tile = (float*)c.lds;
    const int nrb = Nout / 64, nkb = Kout / 64, total = nrb * nkb;
    for (; item < total; item += nitem_stride) {
        const int rb = item % nrb, kb = item / nrb, r0 = rb * 64, k0 = kb * 64;
        __syncthreads();
        const int rr = c.tid & 63; const int col = map.col(r0 + rr);
#pragma unroll
        for (int i = 0; i < 8; ++i) { const int kk = (c.tid >> 6) + 8 * i; const int k = k0 + kk;
            float v = 0.f; if (col >= 0 && k < ksrc) v = W[(size_t)k * ldw + col] * map.scale(r0 + rr, k);
            tile[kk * 65 + rr] = v; }
        __syncthreads();
        const int kk = c.tid & 63;
#pragma unroll
        for (int i = 0; i < 8; ++i) { const int r = (c.tid >> 6) + 8 * i; out[(size_t)(r0 + r) * Kout + k0 + kk] = (bf16)f2bf(tile[kk * 65 + r]); }
    }
    item -= total;
}
__device__ __forceinline__ int ropeperm32(int r5) { return ((r5 >> 2) & 1) * 16 + (r5 >> 3) * 4 + (r5 & 3); }
__device__ __forceinline__ int ropeperm64(int s) { const int hh = s >> 6, w = s & 63, g = w >> 5, r5 = w & 31; return hh * 64 + ((r5 >> 2) & 1) * 32 + g * 16 + (r5 >> 3) * 4 + (r5 & 3); }
struct MapId { __device__ int col(int r) const { return r; } __device__ float scale(int, int) const { return 1.f; } };
struct MapUp { __device__ int col(int r) const { const int pn = r >> 8, s = r & 255; return s < 128 ? 128 * pn + s : FF + 128 * pn + (s - 128); } __device__ float scale(int, int) const { return 1.f; } };
struct MapIn { __device__ int col(int r) const { const int pn = r >> 8, s = r & 255;
        switch (pn) { case 0: return s; case 1: return 1280 + s; case 2: return 1792 + s; case 3: return 256 + s; case 4: return 512 + ropeperm64(s); case 5: return 768 + ropeperm64(s);
            case 6: return 1024 + s; case 7: return 1536 + s; case 8: return s < 128 ? 2048 + s : (s < 160 ? 2176 + ropeperm32(s - 128) : -1); default: return 2208 + (r - 9 * 256); } }
    __device__ float scale(int, int) const { return 1.f; } };
struct MapUq { const float* g; __device__ int col(int r) const { if (r >= 384) return -1; const int h = r / 96, w = r % 96; return w < 64 ? r : h * 96 + 64 + ropeperm32(w - 64); } __device__ float scale(int, int k) const { return g[k]; } };
struct MapUkv { const float* g; __device__ int col(int r) const { return r; } __device__ float scale(int, int k) const { return g[k]; } };
struct MapPool { const float* sc; int g; __device__ int col(int r) const { return r; } __device__ float scale(int r, int) const { return sc[g * 64 + r]; } };

__device__ void conv_layer_a(const Ctx& c, int l) {
    unsigned char* ws = c.ws; int item = c.wg; const int G = c.G;
    conv_mat(c, c.in(3) + (size_t)l * DM * 2 * FF, 2 * FF, DM, DM, 2 * FF, (bf16*)(ws + W_UP), MapUp{}, item, G);
    conv_mat(c, c.in(4) + (size_t)l * FF * DM, DM, FF, FF, DM, (bf16*)(ws + W_DOWN), MapId{}, item, G);
    conv_mat(c, c.in(7) + (size_t)l * DM * NIN, NIN, DM, DM, NINP, (bf16*)(ws + W_IN), MapIn{}, item, G);
    conv_mat(c, c.in(16) + (size_t)l * 256 * 384, 384, 256, 256, 512, (bf16*)(ws + W_UQ), MapUq{c.in(14) + l * 256}, item, G);
    conv_mat(c, c.in(17) + (size_t)l * 128 * 512, 512, 128, 256, 512, (bf16*)(ws + W_UKV), MapUkv{c.in(15) + l * 128}, item, G);
    for (int b = 0; b < 4; ++b) conv_mat(c, c.in(18) + ((size_t)l * 4 + b) * 256 * DM, DM, 256, 256, DM, (bf16*)(ws + W_BR) + (size_t)b * DM * 256, MapId{}, item, G);
    conv_mat(c, c.in(19) + (size_t)l * DM * DM, DM, DM, DM, DM, (bf16*)(ws + W_OUT), MapId{}, item, G);
    for (int g = 0; g < 4; ++g) conv_mat(c, c.in(12) + ((size_t)l * 4 + g) * 64 * 64, 64, 64, 64, 64, (bf16*)(ws + W_POOL) + g * 4096, MapPool{c.in(13) + l * 256, g}, item, G);
    { const float* w = c.in(10) + (size_t)l * 4 * 128 * 128; bf16* o = (bf16*)(ws + W_SGU);
      for (int i = c.wg * NTHREADS + c.tid; i < 4 * 128 * 128; i += G * NTHREADS) { const int s = i & 127, t = (i >> 7) & 127; o[i] = (bf16)f2bf(s <= t ? w[i] : 0.f); } }
}
__device__ void conv_layer_b(const Ctx& c, int l) {
    unsigned char* ws = c.ws; int item = c.wg; const int G = c.G;
    conv_mat(c, c.in(22) + (size_t)l * DM * 2 * FF, 2 * FF, DM, DM, 2 * FF, (bf16*)(ws + W_UP), MapUp{}, item, G);
    conv_mat(c, c.in(23) + (size_t)l * FF * DM, DM, FF, FF, DM, (bf16*)(ws + W_DOWN), MapId{}, item, G);
    conv_mat(c, c.in(24) + (size_t)l * DM * DM, DM, DM, DM, DM, (bf16*)(ws + W_PG), MapId{}, item, G);
    conv_mat(c, c.in(25) + (size_t)l * 256 * DM, DM, 256, 256, DM, (bf16*)(ws + W_PLE), MapId{}, item, G);
}
__device__ void prep_inputs(const Ctx& c) {
    const float* x = c.in(0); bf16* xb = (bf16*)(c.ws + D_XB0);
    for (size_t i = (size_t)c.wg * NTHREADS + c.tid; i < (size_t)T * DM / 4; i += (size_t)c.G * NTHREADS) { const f32x4 v = ((const f32x4*)x)[i]; u32x2 o; o.x = pk2(v.x, v.y); o.y = pk2(v.z, v.w); ((u32x2*)xb)[i] = o; }
    float* rc = (float*)(c.ws + OFF_RCOS); float* rs = (float*)(c.ws + OFF_RSIN); float* mc = (float*)(c.ws + OFF_MCOS); float* ms = (float*)(c.ws + OFF_MSIN);
    for (int i = c.wg * NTHREADS + c.tid; i < T * 48; i += c.G * NTHREADS) {
        const int row = i / 48, j = i % 48; const float fr = c_invf[j];
        const float ang = (float)c.a.pos[row] * fr;
        const double rev = (double)ang * 0.15915494309189533577; double f = rev - rint(rev);
        const double q = rint(f * 4.0); const double g = (f - q * 0.25) * 6.283185307179586476925; const int qi = ((int)q) & 3;
        const double g2 = g * g;
        const double sn = g * (1.0 + g2 * (-1.0 / 6 + g2 * (1.0 / 120 + g2 * (-1.0 / 5040 + g2 * (1.0 / 362880 - g2 * (1.0 / 39916800))))));
        const double cs = 1.0 + g2 * (-0.5 + g2 * (1.0 / 24 + g2 * (-1.0 / 720 + g2 * (1.0 / 40320 + g2 * (-1.0 / 3628800 + g2 * (1.0 / 479001600))))));
        double co, si; if (qi == 0) { co = cs; si = sn; } else if (qi == 1) { co = -sn; si = cs; } else if (qi == 2) { co = -cs; si = -sn; } else { co = sn; si = -cs; }
        if (j < 32) { rc[row * 32 + j] = (float)co; rs[row * 32 + j] = (float)si; } else { mc[row * 16 + j - 32] = (float)co; ms[row * 16 + j - 32] = (float)si; }
    }
}

constexpr int CS_LD = 257;
__device__ void ngemm_tile(const Ctx& c, const bf16* A, int lda, const bf16* Bt, int ldb, int K, int row0, int n0) {
    float* As = (float*)c.lds; float* Bs = As + 64 * 33; float* Cs = Bs + 256 * 33;
    const int tid = c.tid, tr = (tid >> 6) * 8, tc = (tid & 63) * 4;
    float acc[8][4];
#pragma unroll
    for (int i = 0; i < 8; ++i)
#pragma unroll
        for (int j = 0; j < 4; ++j) acc[i][j] = 0.f;
    for (int k0 = 0; k0 < K; k0 += 32) {
        __syncthreads();
        { const int r = tid >> 3, cc = (tid & 7) * 4; const u32x2 v = *(const u32x2*)(A + (size_t)(row0 + r) * lda + k0 + cc);
          As[r * 33 + cc] = bf2f(v.x & 0xffff); As[r * 33 + cc + 1] = bf2f(v.x >> 16); As[r * 33 + cc + 2] = bf2f(v.y & 0xffff); As[r * 33 + cc + 3] = bf2f(v.y >> 16); }
        { const int r = tid >> 1, cc = (tid & 1) * 16; const u32x4* p = (const u32x4*)(Bt + (size_t)(n0 + r) * ldb + k0 + cc); const u32x4 v0 = p[0], v1 = p[1];
          float* d = Bs + r * 33 + cc;
          d[0] = bf2f(v0.x & 0xffff); d[1] = bf2f(v0.x >> 16); d[2] = bf2f(v0.y & 0xffff); d[3] = bf2f(v0.y >> 16); d[4] = bf2f(v0.z & 0xffff); d[5] = bf2f(v0.z >> 16); d[6] = bf2f(v0.w & 0xffff); d[7] = bf2f(v0.w >> 16);
          d[8] = bf2f(v1.x & 0xffff); d[9] = bf2f(v1.x >> 16); d[10] = bf2f(v1.y & 0xffff); d[11] = bf2f(v1.y >> 16); d[12] = bf2f(v1.z & 0xffff); d[13] = bf2f(v1.z >> 16); d[14] = bf2f(v1.w & 0xffff); d[15] = bf2f(v1.w >> 16); }
        __syncthreads();
#pragma unroll 4
        for (int kk = 0; kk < 32; ++kk) {
            float a[8], b[4];
#pragma unroll
            for (int i = 0; i < 8; ++i) a[i] = As[(tr + i) * 33 + kk];
#pragma unroll
            for (int j = 0; j < 4; ++j) b[j] = Bs[(tc + j) * 33 + kk];
#pragma unroll
            for (int i = 0; i < 8; ++i)
#pragma unroll
                for (int j = 0; j < 4; ++j) acc[i][j] += a[i] * b[j];
        }
    }
    __syncthreads();
#pragma unroll
    for (int i = 0; i < 8; ++i)
#pragma unroll
        for (int j = 0; j < 4; ++j) Cs[(tr + i) * CS_LD + tc + j] = acc[i][j];
    __syncthreads();
}
__device__ __forceinline__ float* ncs(const Ctx& c) { return (float*)c.lds + 64 * 33 + 256 * 33; }
template <class Epi> __device__ void ngemm_phase(const Ctx& c, const bf16* A, int lda, const bf16* Bt, int K, int M, int N, const Epi& epi) {
    const int nrm = M / 64, npn = N / 256;
    for (int u = c.wg; u < nrm * npn; u += c.G) { const int rm = u % nrm, pn = u / nrm; ngemm_tile(c, A, lda, Bt, K, K, rm * 64, pn * 256); epi(c, rm * 64, pn, ncs(c)); }
}

struct NEpiUp { bf16* hid; __device__ void operator()(const Ctx& c, int row0, int pn, const float* Cs) const {
    for (int i = c.tid; i < 64 * 128; i += NTHREADS) { const int r = i >> 7, s = i & 127; const float a = Cs[r * CS_LD + s], b = Cs[r * CS_LD + 128 + s]; hid[(size_t)(row0 + r) * FF + 128 * pn + s] = (bf16)f2bf(siluf_(a) * b); } } };
struct NEpiRes { const float* base; float* out; float cacc; const bf16* ple; __device__ void operator()(const Ctx& c, int row0, int pn, const float* Cs) const {
    for (int i = c.tid; i < 64 * 256; i += NTHREADS) { const int r = i >> 8, s = i & 255; const size_t o = (size_t)(row0 + r) * DM + 256 * pn + s; float v = ALPHA * base[o] + cacc * Cs[r * CS_LD + s]; if (ple) v += bf2f(ple[o]); out[o] = v; } } };
__device__ void nln_phase(const Ctx& c, float* io, const float* g, const float* b, bf16* xb) {
    for (int row = c.wg * NWAVES + c.wave; row < T; row += c.G * NWAVES) {
        f32x4 v[4]; float s = 0.f; f32x4* p = (f32x4*)(io + (size_t)row * DM) + c.lane;
#pragma unroll
        for (int j = 0; j < 4; ++j) { v[j] = p[64 * j]; s += (v[j].x + v[j].y) + (v[j].z + v[j].w); }
        const float mean = wave_sum(s) * (1.f / DM); float s2 = 0.f;
#pragma unroll
        for (int j = 0; j < 4; ++j) { v[j] = v[j] - mean; s2 += (v[j].x * v[j].x + v[j].y * v[j].y) + (v[j].z * v[j].z + v[j].w * v[j].w); }
        const float rstd = 1.f / sqrtf(wave_sum(s2) * (1.f / DM) + LN_EPS);
#pragma unroll
        for (int j = 0; j < 4; ++j) { const f32x4 gg = ((const f32x4*)g)[c.lane + 64 * j], bb = ((const f32x4*)b)[c.lane + 64 * j]; const f32x4 o = v[j] * rstd * gg + bb; p[64 * j] = o;
            u32x2 w; w.x = pk2(o.x, o.y); w.y = pk2(o.z, o.w); ((u32x2*)(xb + (size_t)row * DM))[c.lane + 64 * j] = w; }
    }
}
struct NEpiIn { unsigned char* ws; __device__ void operator()(const Ctx& c, int row0, int pn, const float* Cs) const {
    const float* rcos = (const float*)(ws + OFF_RCOS); const float* rsin = (const float*)(ws + OFF_RSIN); const float* mcos = (const float*)(ws + OFF_MCOS); const float* msin = (const float*)(ws + OFF_MSIN);
    if (pn >= 9) { bf16* G = (bf16*)(ws + OFF_E); for (int i = c.tid; i < 64 * 256; i += NTHREADS) { const int r = i >> 8, s = i & 255; G[(size_t)(row0 + r) * 4096 + (pn - 9) * 256 + s] = (bf16)f2bf(sigmoidf_(Cs[r * CS_LD + s])); } return; }
    bf16* O = c.D(pn < 3 ? pn : pn + 1);
    for (int i = c.tid; i < 64 * 256; i += NTHREADS) { const int r = i >> 8, s = i & 255; const int row = row0 + r; float v = Cs[r * CS_LD + s];
        if (pn == 0 || pn == 3) v = gelu_tanh(v);
        else if (pn == 1) v = siluf_(v);
        else if (pn == 4 || pn == 5) { const int w = s & 63, g = w >> 5, r5 = w & 31, n = (r5 >> 2) & 1, fi = g * 16 + (r5 >> 3) * 4 + (r5 & 3); const float other = Cs[r * CS_LD + (s ^ 4)];
            const float co = rcos[row * 32 + fi], si = rsin[row * 32 + fi]; v = n == 0 ? v * co - other * si : other * si + v * co; if (pn == 5) v *= 0.125f; }
        else if (pn == 8 && s >= 128 && s < 160) { const int r5 = s - 128, n = (r5 >> 2) & 1, fi = (r5 >> 3) * 4 + (r5 & 3); const float other = Cs[r * CS_LD + (s ^ 4)];
            const float co = mcos[row * 16 + fi], si = msin[row * 16 + fi]; v = n == 0 ? v * co - other * si : other * si + v * co; }
        O[(size_t)row * 256 + s] = (bf16)f2bf(v); } } };
struct NEpiMla { unsigned char* ws; int which; const bf16* A; __device__ void operator()(const Ctx& c, int row0, int pn, const float* Cs) const {
    float* rs = (float*)c.lds;
    __syncthreads();
    if (c.tid < 64) { const bf16* a = A + (size_t)(row0 + c.tid) * 256; float s = 0.f; const int n = which == 0 ? 256 : 128; for (int k = 0; k < n; ++k) { const float v = bf2f(a[k]); s += v * v; } rs[c.tid] = 1.0f / sqrtf(s / (float)n + RMS_EPS); }
    __syncthreads();
    const float* mcos = (const float*)(ws + OFF_MCOS); const float* msin = (const float*)(ws + OFF_MSIN);
    for (int i = c.tid; i < 64 * 256; i += NTHREADS) { const int r = i >> 8, s = i & 255, row = row0 + r, sg = pn * 256 + s; float v = Cs[r * CS_LD + s] * rs[r];
        if (which == 0) { if (sg >= 384) continue; const int w = sg % 96;
            if (w >= 64) { const int r5 = w - 64, n = (r5 >> 2) & 1, fi = (r5 >> 3) * 4 + (r5 & 3); const float other = Cs[r * CS_LD + (s ^ 4)] * rs[r]; const float co = mcos[row * 16 + fi], si = msin[row * 16 + fi]; v = n == 0 ? v * co - other * si : other * si + v * co; }
            ((bf16*)(ws + C_QM))[(size_t)row * 384 + sg] = (bf16)f2bf(v * QSCALE); }
        else { const int h = sg >> 7, w = sg & 127; if (w < 64) ((bf16*)(ws + C_KN))[(size_t)row * 256 + h * 64 + w] = (bf16)f2bf(v);
            else { const int b = row >> 12, t = row & 4095; ((bf16*)(ws + C_VT))[((size_t)(b * 4 + h) * 64 + (w - 64)) * SEQ + t] = (bf16)f2bf(v); } } }
    __syncthreads(); } };
__device__ void nret_kv(const Ctx& c) {
    const bf16* K = c.D(6); const bf16* V = c.D(7); bf16* st = (bf16*)(c.ws + OFF_F);
    for (int task = c.wg; task < NB * 64 * 4; task += c.G) { const int h = task & 3, n = (task >> 2) & 63, b = task >> 8; const size_t r0 = (size_t)b * SEQ + n * 64; const float lg = lg2g(h);
        for (int i = c.tid; i < 4096; i += NTHREADS) { const int e = i >> 6, d = i & 63; float s = 0.f;
            for (int j = 0; j < 64; ++j) s += bf2f(V[(r0 + j) * 256 + h * 64 + e]) * exp2f(lg * (float)(63 - j)) * bf2f(K[(r0 + j) * 256 + h * 64 + d]);
            st[(size_t)task * 4096 + i] = (bf16)f2bf(s); } }
}
__device__ void nret_scan(const Ctx& c) {
    bf16* st = (bf16*)(c.ws + OFF_F);
    for (int i = c.wg * NTHREADS + c.tid; i < NB * 4 * 4096; i += c.G * NTHREADS) { const int ed = i & 4095, h = (i >> 12) & 3, b = i >> 14; const float cd = exp2f(lg2g(h) * 64.f); float S = 0.f;
        for (int n = 0; n < 64; ++n) { bf16* p = st + ((size_t)((b * 64 + n) * 4 + h)) * 4096 + ed; const float kv = bf2f(*p); *p = (bf16)f2bf(S); S = S * cd + kv; } }
}
__device__ void nsgu(const Ctx& c, int l) {
    float* vp = (float*)c.lds;
    const bf16* GV = c.D(4); bf16* U = c.D(0); const bf16* Wm = (const bf16*)(c.ws + W_SGU);
    const float* lg = c.in(8) + l * 256; const float* lb = c.in(9) + l * 256; const float* sb = c.in(11) + l * 512;
    for (int unit = c.wg; unit < T / 128; unit += c.G) { const size_t r0 = (size_t)unit * 128;
        __syncthreads();
        for (int t = c.wave; t < 128; t += NWAVES) { const bf16* p = GV + (r0 + t) * 256 + c.lane * 4; const u32x2 w = *(const u32x2*)p; float v[4] = {bf2f(w.x & 0xffff), bf2f(w.x >> 16), bf2f(w.y & 0xffff), bf2f(w.y >> 16)};
            const float mean = wave_sum(v[0] + v[1] + v[2] + v[3]) * (1.f / 256); float s2 = 0.f;
#pragma unroll
            for (int j = 0; j < 4; ++j) { v[j] -= mean; s2 += v[j] * v[j]; }
            const float rstd = 1.f / sqrtf(wave_sum(s2) * (1.f / 256) + LN_EPS);
#pragma unroll
            for (int j = 0; j < 4; ++j) vp[t * 257 + c.lane * 4 + j] = bfround(v[j] * rstd * lg[c.lane * 4 + j] + lb[c.lane * 4 + j]); }
        __syncthreads();
        const int ch = c.tid & 255, g = ch >> 6;
        for (int t = c.tid >> 8; t < 128; t += 2) { float acc = 0.f; const bf16* wr = Wm + ((size_t)g * 128 + t) * 128;
            for (int s = 0; s <= t; ++s) acc += bf2f(wr[s]) * vp[s * 257 + ch];
            acc += sb[g * 128 + t]; bf16* u = U + (r0 + t) * 256 + ch; *u = (bf16)f2bf(bf2f(*u) * acc); } }
}
__device__ void npool(const Ctx& c) {
    float* pl = (float*)c.lds;
    const bf16* Z = c.D(8); bf16* Y = c.D(2); const bf16* Wp = (const bf16*)(c.ws + W_POOL);
    for (int unit = c.wg; unit < T / 64; unit += c.G) { const size_t r0 = (size_t)unit * 64;
        __syncthreads();
        for (int i = c.tid; i < 64 * 256; i += NTHREADS) { const int r = i >> 8, ch = i & 255, g = ch >> 6, w = 2 << g; const int tl = (int)((r0 + r) & 4095); const int cnt = tl + 1 < w ? tl + 1 : w; float s = 0.f;
            for (int k = 0; k < cnt; ++k) s += bf2f(Z[(r0 + r - k) * 256 + ch]);
            pl[r * 257 + ch] = bfround(s / (float)cnt - bf2f(Z[(r0 + r) * 256 + ch])); }
        __syncthreads();
        for (int i = c.tid; i < 64 * 256; i += NTHREADS) { const int r = i >> 8, ch = i & 255, g = ch >> 6, d = ch & 63; float acc = 0.f; const bf16* w = Wp + (g * 64 + d) * 64;
            for (int k = 0; k < 64; ++k) acc += pl[r * 257 + g * 64 + k] * bf2f(w[k]);
            Y[(r0 + r) * 256 + ch] = (bf16)f2bf(acc); } }
}
__device__ void nret_apply(const Ctx& c) {
    float* Sc = (float*)c.lds; float* Yl = Sc + 64 * 65;
    const bf16* Q = c.D(5); const bf16* K = c.D(6); const bf16* V = c.D(7); bf16* Gt = c.D(1); const bf16* st = (const bf16*)(c.ws + OFF_F);
    for (int task = c.wg; task < NB * 64 * 4; task += c.G) { const int h = task & 3, n = (task >> 2) & 63, b = task >> 8; const size_t r0 = (size_t)b * SEQ + n * 64; const float lg = lg2g(h);
        __syncthreads();
        for (int i = c.tid; i < 4096; i += NTHREADS) { const int qi = i >> 6, kj = i & 63; float s = 0.f;
            for (int d = 0; d < 64; ++d) s += bf2f(Q[(r0 + qi) * 256 + h * 64 + d]) * bf2f(K[(r0 + kj) * 256 + h * 64 + d]);
            const int ad = qi > kj ? qi - kj : kj - qi; Sc[qi * 65 + kj] = bfround(s * exp2f(lg * (float)ad)); }
        __syncthreads();
        for (int i = c.tid; i < 4096; i += NTHREADS) { const int qi = i >> 6, e = i & 63; float y = 0.f, y2 = 0.f;
            for (int j = 0; j < 64; ++j) y += Sc[qi * 65 + j] * bf2f(V[(r0 + j) * 256 + h * 64 + e]);
            const bf16* pv = st + (size_t)task * 4096 + e * 64;
            for (int d = 0; d < 64; ++d) y2 += bf2f(Q[(r0 + qi) * 256 + h * 64 + d]) * bf2f(pv[d]);
            Yl[qi * 65 + e] = y + exp2f(lg * (float)(qi + 1)) * y2; }
        __syncthreads();
        for (int i = c.tid; i < 4096; i += NTHREADS) { const int qi = i >> 6, e = i & 63; float m = 0.f; for (int k = 0; k < 64; ++k) m += Yl[qi * 65 + k]; m *= (1.f / 64); float v = 0.f; for (int k = 0; k < 64; ++k) { const float dd = Yl[qi * 65 + k] - m; v += dd * dd; }
            const float rstd = 1.f / sqrtf(v * (1.f / 64) + GN_EPS); bf16* g = Gt + (r0 + qi) * 256 + h * 64 + e; *g = (bf16)f2bf(bf2f(*g) * (Yl[qi * 65 + e] - m) * rstd); } }
}
__device__ void nattn(const Ctx& c) {
    const bf16* Qm = (const bf16*)(c.ws + C_QM); const bf16* Kn = (const bf16*)(c.ws + C_KN); const bf16* Vt = (const bf16*)(c.ws + C_VT); const bf16* KR = c.D(9); bf16* Y = c.D(3);
    const int sub = c.tid & 3;
    for (int blk = c.wg; blk < NB * 4 * (SEQ / 128); blk += c.G) {
        const int qb = blk & 31, h = (blk >> 5) & 3, b = blk >> 7; const int t = qb * 128 + (c.tid >> 2); const size_t row = (size_t)b * SEQ + t;
        float q[24];
#pragma unroll
        for (int d = 0; d < 16; ++d) q[d] = bf2f(Qm[row * 384 + h * 96 + sub * 16 + d]);
#pragma unroll
        for (int d = 0; d < 8; ++d) q[16 + d] = bf2f(Qm[row * 384 + h * 96 + 64 + sub * 8 + d]);
        float o[16];
#pragma unroll
        for (int e = 0; e < 16; ++e) o[e] = 0.f;
        float m = -1e30f, l = 0.f; const int nk = ((t >> 6) + 1) * 64;
        const int nkmax = ((qb * 128 + 127) >> 6) * 64 + 64;
        for (int k = 0; k < nkmax; ++k) { const size_t kr = (size_t)b * SEQ + k; float s = 0.f;
            const u32x4 k0 = *(const u32x4*)(Kn + kr * 256 + h * 64 + sub * 16), k1 = *(const u32x4*)(Kn + kr * 256 + h * 64 + sub * 16 + 8), k2 = *(const u32x4*)(KR + kr * 256 + 128 + sub * 8);
            s += q[0] * bf2f(k0.x & 0xffff) + q[1] * bf2f(k0.x >> 16) + q[2] * bf2f(k0.y & 0xffff) + q[3] * bf2f(k0.y >> 16) + q[4] * bf2f(k0.z & 0xffff) + q[5] * bf2f(k0.z >> 16) + q[6] * bf2f(k0.w & 0xffff) + q[7] * bf2f(k0.w >> 16);
            s += q[8] * bf2f(k1.x & 0xffff) + q[9] * bf2f(k1.x >> 16) + q[10] * bf2f(k1.y & 0xffff) + q[11] * bf2f(k1.y >> 16) + q[12] * bf2f(k1.z & 0xffff) + q[13] * bf2f(k1.z >> 16) + q[14] * bf2f(k1.w & 0xffff) + q[15] * bf2f(k1.w >> 16);
            s += q[16] * bf2f(k2.x & 0xffff) + q[17] * bf2f(k2.x >> 16) + q[18] * bf2f(k2.y & 0xffff) + q[19] * bf2f(k2.y >> 16) + q[20] * bf2f(k2.z & 0xffff) + q[21] * bf2f(k2.z >> 16) + q[22] * bf2f(k2.w & 0xffff) + q[23] * bf2f(k2.w >> 16);
            s += __shfl_xor(s, 1); s += __shfl_xor(s, 2);
            if (k < nk) { const float mn = fmaxf(m, s), cr = exp2f(m - mn), p = exp2f(s - mn); l = l * cr + p; m = mn;
#pragma unroll
                for (int e = 0; e < 16; ++e) o[e] = o[e] * cr + p * bf2f(Vt[((size_t)(b * 4 + h) * 64 + sub * 16 + e) * SEQ + k]); } }
        const float il = 1.f / l;
#pragma unroll
        for (int e = 0; e < 16; e += 2) *(unsigned*)(Y + row * 256 + h * 64 + sub * 16 + e) = pk2(o[e] * il, o[e + 1] * il);
    }
}
__device__ void nbranch(const Ctx& c) {
    bf16* MG = (bf16*)(c.ws + OFF_C); const bf16* G = (const bf16*)(c.ws + OFF_E);
    for (int u = c.wg; u < (T / 64) * 4; u += c.G) { const int rm = u % (T / 64), pn = u / (T / 64), row0 = rm * 64;
        for (int b = 0; b < 4; ++b) { ngemm_tile(c, c.D(b), 256, (const bf16*)(c.ws + W_BR) + (size_t)b * DM * 256, 256, 256, row0, pn * 256); const float* Cs = ncs(c);
            for (int i = c.tid; i < 64 * 256; i += NTHREADS) { const int r = i >> 8, s = i & 255; const size_t o = (size_t)(row0 + r) * DM + pn * 256 + s; float v = bf2f(G[(size_t)(row0 + r) * 4096 + b * DM + pn * 256 + s]) * Cs[r * CS_LD + s]; if (b) v += bf2f(MG[o]); MG[o] = (bf16)f2bf(v); } } }
}
struct NEpiPle0 { bf16* ple; __device__ void operator()(const Ctx& c, int row0, int pn, const float* Cs) const { for (int i = c.tid; i < 64 * 256; i += NTHREADS) { const int r = i >> 8, s = i & 255; ple[(size_t)(row0 + r) * DM + pn * 256 + s] = (bf16)f2bf(Cs[r * CS_LD + s]); } } };
struct NEpiPle1 { bf16* ple; __device__ void operator()(const Ctx& c, int row0, int pn, const float* Cs) const { for (int i = c.tid; i < 64 * 256; i += NTHREADS) { const int r = i >> 8, s = i & 255; bf16* p = ple + (size_t)(row0 + r) * DM + pn * 256 + s; *p = (bf16)f2bf(sigmoidf_(Cs[r * CS_LD + s]) * bf2f(*p)); } } };
__device__ void conv_p(const Ctx& c, int l) {
    const float* p = c.in(1) + (size_t)l * T * 256; bf16* pb = (bf16*)(c.ws + D_PB);
    for (size_t i = (size_t)c.wg * NTHREADS + c.tid; i < (size_t)T * 256 / 4; i += (size_t)c.G * NTHREADS) { const f32x4 v = ((const f32x4*)p)[i]; u32x2 o; o.x = pk2(v.x, v.y); o.y = pk2(v.z, v.w); ((u32x2*)pb)[i] = o; }
}

constexpr int PH_PER_LAYER = 14, N_PHASES = DEPTH * PH_PER_LAYER;
template <int k> __device__ __forceinline__ void run_phase(const Ctx& c, int l) {
    unsigned char* ws = c.ws;
    if constexpr (k == 0) { conv_layer_a(c, l); if (l == 0) prep_inputs(c); }
    if constexpr (k == 1) ngemm_phase(c, (const bf16*)(ws + D_XB0), DM, (const bf16*)(ws + W_UP), DM, T, 2 * FF, NEpiUp{(bf16*)(ws + OFF_E)});
    if constexpr (k == 2) ngemm_phase(c, (const bf16*)(ws + OFF_E), FF, (const bf16*)(ws + W_DOWN), FF, T, DM, NEpiRes{l == 0 ? c.in(0) : c.out, c.out, 0.5f, nullptr});
    if constexpr (k == 3) nln_phase(c, c.out, c.in(5) + l * DM, c.in(6) + l * DM, (bf16*)(ws + OFF_C));
    if constexpr (k == 4) ngemm_phase(c, (const bf16*)(ws + OFF_C), DM, (const bf16*)(ws + W_IN), DM, T, NINP, NEpiIn{ws});
    if constexpr (k == 5) { ngemm_phase(c, c.D(2), 256, (const bf16*)(ws + W_UQ), 256, T, 512, NEpiMla{ws, 0, c.D(2)});
            ngemm_phase(c, c.D(9), 256, (const bf16*)(ws + W_UKV), 256, T, 512, NEpiMla{ws, 1, c.D(9)});
            nret_kv(c); conv_layer_b(c, l); }
    if constexpr (k == 6) { nret_scan(c); nsgu(c, l); npool(c); }
    if constexpr (k == 7) { nattn(c); nret_apply(c); }
    if constexpr (k == 8) nbranch(c);
    if constexpr (k == 9) { conv_p(c, l); ngemm_phase(c, (const bf16*)(ws + OFF_C), DM, (const bf16*)(ws + W_OUT), DM, T, DM, NEpiRes{c.out, c.out, 1.0f, nullptr}); }
    if constexpr (k == 10) nln_phase(c, c.out, c.in(20) + l * DM, c.in(21) + l * DM, (bf16*)(ws + D_X2B));
    if constexpr (k == 11) { ngemm_phase(c, (const bf16*)(ws + D_X2B), DM, (const bf16*)(ws + W_UP), DM, T, 2 * FF, NEpiUp{(bf16*)(ws + OFF_E)});
             ngemm_phase(c, (const bf16*)(ws + D_PB), 256, (const bf16*)(ws + W_PLE), 256, T, DM, NEpiPle0{(bf16*)(ws + OFF_C)});
             __syncthreads();
             ngemm_phase(c, (const bf16*)(ws + D_X2B), DM, (const bf16*)(ws + W_PG), DM, T, DM, NEpiPle1{(bf16*)(ws + OFF_C)}); }
    if constexpr (k == 12) ngemm_phase(c, (const bf16*)(ws + OFF_E), FF, (const bf16*)(ws + W_DOWN), FF, T, DM, NEpiRes{c.out, c.out, 0.5f, (const bf16*)(ws + OFF_C)});
    if constexpr (k == 13) nln_phase(c, c.out, c.in(26) + l * DM, c.in(27) + l * DM, (bf16*)(ws + D_XB0));
}

template <int K> __global__ void __launch_bounds__(NTHREADS, 2) mk_phase(Args args) {
    extern __shared__ __attribute__((aligned(16))) unsigned char lds_raw[];
    Ctx c; c.a = args; c.ws = args.ws; c.out = args.out; c.lds = (char*)lds_raw; c.tid = threadIdx.x; c.lane = c.tid & 63; c.wave = c.tid >> 6; c.wg = blockIdx.x; c.G = gridDim.x;
    run_phase<K>(c, args.ph_lo);
}
template <int K> static void launch_phase(const Args& a, hipStream_t stream) {
    static bool attr = false; if (!attr) { (void)hipFuncSetAttribute((const void*)mk_phase<K>, hipFuncAttributeMaxDynamicSharedMemorySize, LDS_BYTES); attr = true; }
    hipLaunchKernelGGL(mk_phase<K>, dim3(256), dim3(NTHREADS), LDS_BYTES, stream, a);
}

extern "C" void kernel_launch(void* const* d_in, const int* in_sizes, int n_in, void* d_out, int out_size, void* d_ws, size_t ws_size, hipStream_t stream) {
    static int ready = 0;
    if (!ready) {
        if (n_in != 28 || out_size != T * DM || ws_size < WS_END) { fprintf(stderr, "kernel_launch: unexpected sizes n_in %d out %d ws %zu (need %zu)\n", n_in, out_size, ws_size, (size_t)WS_END); ready = -1; return; }
        ready = 1;
    }
    if (ready < 0) return;
    (void)in_sizes;
    (void)hipMemsetAsync((char*)d_ws + OFF_CTL, 0, CTL_BYTES, stream);
    Args a{};
    for (int i = 0; i < 28; ++i) a.in[i] = (const float*)d_in[i];
    a.pos = (const int*)d_in[2]; a.out = (float*)d_out; a.ws = (unsigned char*)d_ws;
    for (int l = 0; l < DEPTH; ++l) { a.ph_lo = l; a.ph_hi = l + 1;
        launch_phase<0>(a, stream); launch_phase<1>(a, stream); launch_phase<2>(a, stream); launch_phase<3>(a, stream); launch_phase<4>(a, stream); launch_phase<5>(a, stream); launch_phase<6>(a, stream);
        launch_phase<7>(a, stream); launch_phase<8>(a, stream); launch_phase<9>(a, stream); launch_phase<10>(a, stream); launch_phase<11>(a, stream); launch_phase<12>(a, stream); launch_phase<13>(a, stream); }
}
```
